# Optimizing an MI355X kernel written in HIP

```python
import math
import jax, jax.numpy as jnp
from jax import lax
import numpy as np

D_MODEL = 1024
BATCH = 32
SEQ = 2048
DEPTH = 4

ATTN_WIDTH = D_MODEL // 2
SSM_WIDTH = D_MODEL - ATTN_WIDTH
HEAD_DIM = 64
N_HEADS = ATTN_WIDTH // HEAD_DIM
DILATION_PAIRS = ((128, 1), (512, 4), (2048, 16))
ROPE_THETA = 10000.0
SSM_GROUP_DIM = 16
SSM_GROUPS = SSM_WIDTH // SSM_GROUP_DIM
SSM_STATE = 64
DT_MIN = 0.001
DT_MAX = 0.1
D_FF = 4 * D_MODEL
IN_WIDTH = 3 * ATTN_WIDTH + SSM_WIDTH
LN_EPS = 1e-5
RMS_EPS = 1e-6
NEG_INF = -1e30
DEEPNORM_ALPHA = (2.0 * DEPTH) ** 0.25
DEEPNORM_BETA = (8.0 * DEPTH) ** -0.25

kernel_name = "hymba_s5_dilated_attn_deepnorm_trunk"


def layer_norm(x, g, b):
    xf = x.astype(jnp.float32)
    mu = jnp.mean(xf, axis=-1, keepdims=True)
    var = jnp.mean(jnp.square(xf - mu), axis=-1, keepdims=True)
    y = (xf - mu) * lax.rsqrt(var + LN_EPS) * g.astype(jnp.float32) + b.astype(jnp.float32)
    return y.astype(x.dtype)


def rms_norm(x, g):
    xf = x.astype(jnp.float32)
    y = xf * lax.rsqrt(jnp.mean(jnp.square(xf), axis=-1, keepdims=True) + RMS_EPS)
    return y * g.astype(jnp.float32)


def rope(t, positions):
    half = t.shape[-1] // 2
    inv_freq = ROPE_THETA ** (-jnp.arange(half, dtype=jnp.float32) * 2.0 / t.shape[-1])
    ang = positions.astype(jnp.float32)[..., None] * inv_freq
    cos = jnp.cos(ang)[:, :, None, :]
    sin = jnp.sin(ang)[:, :, None, :]
    t1, t2 = t[..., :half], t[..., half:]
    return jnp.concatenate([t1 * cos - t2 * sin, t1 * sin + t2 * cos], axis=-1)


def dilated_branch(q, k, v, window, dilation):
    bsz, s, h, e = q.shape
    nk = window // dilation
    qb_size = nk
    sub_len = s // dilation
    nb = -(-sub_len // qb_size)
    padded = nb * qb_size
    pad = padded - sub_len

    def to_sub(t):
        return t.reshape(bsz, sub_len, dilation, h, e).transpose(0, 2, 3, 1, 4)

    qs = jnp.pad(to_sub(q), ((0, 0), (0, 0), (0, 0), (0, pad), (0, 0)))
    ks = jnp.pad(to_sub(k), ((0, 0), (0, 0), (0, 0), (qb_size, pad), (0, 0)))
    vs = jnp.pad(to_sub(v), ((0, 0), (0, 0), (0, 0), (qb_size, pad), (0, 0)))
    qblk = qs.reshape(bsz, dilation, h, nb, qb_size, e)
    kb = ks.reshape(bsz, dilation, h, nb + 1, qb_size, e)
    vb = vs.reshape(bsz, dilation, h, nb + 1, qb_size, e)
    keys = jnp.concatenate([kb[:, :, :, :-1], kb[:, :, :, 1:]], axis=4)
    vals = jnp.concatenate([vb[:, :, :, :-1], vb[:, :, :, 1:]], axis=4)

    scores = jnp.einsum('bdhnqe,bdhnke->bdhnqk', qblk, keys)
    qi = jnp.arange(qb_size)[:, None]
    kj = jnp.arange(2 * qb_size)[None, :]
    dist = qi + qb_size - kj
    key_idx = jnp.arange(nb)[:, None, None] * qb_size - qb_size + kj[None]
    valid = (dist >= 0)[None] & (dist <= nk)[None] & (key_idx >= 0)
    scores = jnp.where(valid, scores, NEG_INF)
    m = jnp.max(scores, axis=-1, keepdims=True)
    p = jnp.exp(scores - m)
    den = jnp.sum(p, axis=-1, keepdims=True)
    o = jnp.einsum('bdhnqk,bdhnke->bdhnqe', p, vals) / den
    lse = (m + jnp.log(den))[..., 0]

    o = o.reshape(bsz, dilation, h, padded, e)[:, :, :, :sub_len]
    o = o.transpose(0, 3, 1, 2, 4).reshape(bsz, s, h, e)
    lse = lse.reshape(bsz, dilation, h, padded)[:, :, :, :sub_len]
    lse = lse.transpose(0, 3, 1, 2).reshape(bsz, s, h)
    return o, lse


def dilated_attention(q, k, v, positions):
    bsz, s, _ = q.shape
    q = rope(q.astype(jnp.float32).reshape(bsz, s, N_HEADS, HEAD_DIM), positions)
    k = rope(k.astype(jnp.float32).reshape(bsz, s, N_HEADS, HEAD_DIM), positions)
    v = v.astype(jnp.float32).reshape(bsz, s, N_HEADS, HEAD_DIM)
    q = q * (HEAD_DIM ** -0.5)
    outs, lses = [], []
    for window, dilation in DILATION_PAIRS:
        o, lse = dilated_branch(q, k, v, window, dilation)
        outs.append(o)
        lses.append(lse)
    w = jax.nn.softmax(jnp.stack(lses, axis=0), axis=0)
    o = jnp.sum(w[..., None] * jnp.stack(outs, axis=0), axis=0)
    return o.reshape(bsz, s, ATTN_WIDTH)


def _ssm_combine(e1, e2):
    a1r, a1i, b1r, b1i = e1
    a2r, a2i, b2r, b2i = e2
    ar = a2r * a1r - a2i * a1i
    ai = a2r * a1i + a2i * a1r
    br = a2r * b1r - a2i * b1i + b2r
    bi = a2r * b1i + a2i * b1r + b2i
    return (ar, ai, br, bi)


def s5_mixer(u, a_re, a_im, log_dt, b_re, b_im, c_re, c_im, d_skip, w_glu, b_glu):
    bsz, s, _ = u.shape
    f32 = jnp.float32
    uf = u.astype(f32).reshape(bsz, s, SSM_GROUPS, SSM_GROUP_DIM)
    a_re = a_re.astype(f32)
    a_im = a_im.astype(f32)
    dt = jnp.exp(log_dt.astype(f32))[:, None]
    mag = jnp.exp(a_re * dt)
    ang = a_im * dt
    lb_re = mag * jnp.cos(ang)
    lb_im = mag * jnp.sin(ang)
    den = a_re * a_re + a_im * a_im
    nr = lb_re - 1.0
    ni = lb_im
    cr = (nr * a_re + ni * a_im) / den
    ci = (ni * a_re - nr * a_im) / den
    b_re = b_re.astype(f32)
    b_im = b_im.astype(f32)
    bb_re = cr[..., None] * b_re - ci[..., None] * b_im
    bb_im = cr[..., None] * b_im + ci[..., None] * b_re
    bu_re = jnp.einsum('bsgn,gpn->bsgp', uf, bb_re)
    bu_im = jnp.einsum('bsgn,gpn->bsgp', uf, bb_im)
    lam_re = jnp.broadcast_to(lb_re[None, None], (1, s, SSM_GROUPS, SSM_STATE))
    lam_im = jnp.broadcast_to(lb_im[None, None], (1, s, SSM_GROUPS, SSM_STATE))
    _, _, xr, xi = lax.associative_scan(_ssm_combine, (lam_re, lam_im, bu_re, bu_im), axis=1)
    y = (jnp.einsum('bsgp,gnp->bsgn', xr, c_re.astype(f32))
         - jnp.einsum('bsgp,gnp->bsgn', xi, c_im.astype(f32))
         + d_skip.astype(f32) * uf)
    y = jax.nn.gelu(y.reshape(bsz, s, SSM_WIDTH))
    y = y * jax.nn.sigmoid(y @ w_glu.astype(f32) + b_glu.astype(f32))
    return y


def setup_inputs(seed: int = 0) -> dict:
    key = jax.random.key(seed)
    ks = jax.random.split(key, 32)
    L = DEPTH
    nrm = jax.random.normal
    f32 = jnp.float32
    x = nrm(ks[0], (BATCH, SEQ, D_MODEL), f32)
    positions = (jax.random.randint(ks[1], (BATCH, 1), 0, 1024, dtype=jnp.int32)
                 + jnp.arange(SEQ, dtype=jnp.int32)[None, :])
    w_in = nrm(ks[2], (L, D_MODEL, IN_WIDTH), f32) * D_MODEL ** -0.5
    attn_gain = 1.0 + 0.02 * nrm(ks[3], (L, ATTN_WIDTH), f32)
    ssm_gain = 1.0 + 0.02 * nrm(ks[4], (L, SSM_WIDTH), f32)
    ssm_a_re = -0.5 + 0.01 * nrm(ks[5], (L, SSM_GROUPS, SSM_STATE), f32)
    ssm_a_im = (math.pi * jnp.arange(SSM_STATE, dtype=f32)[None, None, :]
                + 0.01 * nrm(ks[6], (L, SSM_GROUPS, SSM_STATE), f32))
    ssm_log_dt = jax.random.uniform(ks[7], (L, SSM_GROUPS), f32,
                                    math.log(DT_MIN), math.log(DT_MAX))
    bs = (2.0 * SSM_GROUP_DIM) ** -0.5
    cs = (2.0 * SSM_STATE) ** -0.5
    ssm_b_re = nrm(ks[8], (L, SSM_GROUPS, SSM_STATE, SSM_GROUP_DIM), f32) * bs
    ssm_b_im = nrm(ks[9], (L, SSM_GROUPS, SSM_STATE, SSM_GROUP_DIM), f32) * bs
    ssm_c_re = nrm(ks[10], (L, SSM_GROUPS, SSM_GROUP_DIM, SSM_STATE), f32) * cs
    ssm_c_im = nrm(ks[11], (L, SSM_GROUPS, SSM_GROUP_DIM, SSM_STATE), f32) * cs
    ssm_d = nrm(ks[12], (L, SSM_GROUPS, SSM_GROUP_DIM), f32)
    w_glu = nrm(ks[13], (L, SSM_WIDTH, SSM_WIDTH), f32) * SSM_WIDTH ** -0.5
    b_glu = 0.01 * nrm(ks[14], (L, SSM_WIDTH), f32)
    w_out = nrm(ks[15], (L, D_MODEL, D_MODEL), f32) * D_MODEL ** -0.5 * DEEPNORM_BETA
    b_out = 0.01 * nrm(ks[16], (L, D_MODEL), f32)
    ln1_g = 1.0 + 0.02 * nrm(ks[17], (L, D_MODEL), f32)
    ln1_b = 0.01 * nrm(ks[18], (L, D_MODEL), f32)
    w_ff1 = nrm(ks[19], (L, D_MODEL, D_FF), f32) * D_MODEL ** -0.5
    b_ff1 = 0.01 * nrm(ks[20], (L, D_FF), f32)
    w_ff2 = nrm(ks[21], (L, D_FF, D_MODEL), f32) * D_FF ** -0.5 * DEEPNORM_BETA
    b_ff2 = 0.01 * nrm(ks[22], (L, D_MODEL), f32)
    ln2_g = 1.0 + 0.02 * nrm(ks[23], (L, D_MODEL), f32)
    ln2_b = 0.01 * nrm(ks[24], (L, D_MODEL), f32)
    return {"x": x, "positions": positions, "w_in": w_in, "attn_gain": attn_gain,
            "ssm_gain": ssm_gain, "ssm_a_re": ssm_a_re, "ssm_a_im": ssm_a_im,
            "ssm_log_dt": ssm_log_dt, "ssm_b_re": ssm_b_re, "ssm_b_im": ssm_b_im,
            "ssm_c_re": ssm_c_re, "ssm_c_im": ssm_c_im, "ssm_d": ssm_d,
            "w_glu": w_glu, "b_glu": b_glu, "w_out": w_out, "b_out": b_out,
            "ln1_g": ln1_g, "ln1_b": ln1_b, "w_ff1": w_ff1, "b_ff1": b_ff1,
            "w_ff2": w_ff2, "b_ff2": b_ff2, "ln2_g": ln2_g, "ln2_b": ln2_b}


def reference(x, positions, w_in, attn_gain, ssm_gain, ssm_a_re, ssm_a_im, ssm_log_dt,
              ssm_b_re, ssm_b_im, ssm_c_re, ssm_c_im, ssm_d, w_glu, b_glu, w_out, b_out,
              ln1_g, ln1_b, w_ff1, b_ff1, w_ff2, b_ff2, ln2_g, ln2_b):
    h = x
    for l in range(DEPTH):
        proj = h @ w_in[l]
        q = proj[..., :ATTN_WIDTH]
        k = proj[..., ATTN_WIDTH:2 * ATTN_WIDTH]
        v = proj[..., 2 * ATTN_WIDTH:3 * ATTN_WIDTH]
        u = proj[..., 3 * ATTN_WIDTH:]
        attn = dilated_attention(q, k, v, positions)
        ssm = s5_mixer(u, ssm_a_re[l], ssm_a_im[l], ssm_log_dt[l], ssm_b_re[l], ssm_b_im[l],
                       ssm_c_re[l], ssm_c_im[l], ssm_d[l], w_glu[l], b_glu[l])
        mixed = jnp.concatenate([rms_norm(attn, attn_gain[l]), rms_norm(ssm, ssm_gain[l])],
                                axis=-1).astype(h.dtype)
        mix_out = mixed @ w_out[l] + b_out[l]
        h = layer_norm(DEEPNORM_ALPHA * h + mix_out, ln1_g[l], ln1_b[l])
        ff = jnp.square(jax.nn.relu(h @ w_ff1[l] + b_ff1[l])) @ w_ff2[l] + b_ff2[l]
        h = layer_norm(DEEPNORM_ALPHA * h + ff, ln2_g[l], ln2_b[l])
    return h
```

```cpp
#include <hip/hip_runtime.h>
#include <hip/hip_cooperative_groups.h>
#include <cstdio>
#include <cstdint>
namespace cg = cooperative_groups;

namespace pg8 {
#define PG8_LAS __attribute__((address_space(3)))
typedef unsigned short bf16_t;
typedef short bf16x8 __attribute__((ext_vector_type(8)));
typedef float f32x4 __attribute__((ext_vector_type(4)));
typedef unsigned u32x4 __attribute__((ext_vector_type(4)));
constexpr int BM = 256, BK = 64, HALF = 128, HTB = HALF * BK * 2  , STAGE_BYTES = 8 * HTB, NXCD = 8, WGM = 8;

__host__ __device__ __forceinline__ int lds_byte(int r, int c) { const int st = (r >> 4) * 2 + (c >> 5), rr = r & 15, cc = c & 31, ob = rr * 64 + cc * 2; return st * 1024 + (ob ^ (((ob >> 9) & 1) << 5)); }
__host__ __device__ __forceinline__ void stage_rc(int b, int& R, int& C) { const int st = b / 1024, sb = b % 1024, swz = sb ^ (((sb >> 9) & 1) << 5); R = (st >> 1) * 16 + swz / 64; C = (st & 1) * 32 + (swz % 64) / 2; }
__host__ __device__ __forceinline__ int perm32(int rho) { const int n = rho >> 4, i = rho & 15; return 8 * (i >> 2) + 4 * n + (i & 3); }

struct Unit { int pm, pn; };
struct Gemm { const bf16_t* A; const bf16_t* Bt; int M, N, K; };

struct StaticOrder {
    int nM, nN, nwg, G, c;
    __host__ __device__ void init(int M, int N, int G_, int c_) { nM = M / BM; nN = N / BM; nwg = nM * nN; G = G_; c = c_; }
    __host__ __device__ bool next(int i, Unit& u) const {
        const long L = (long)i * G + c; if (L >= nwg) return false;
        int wgid = (int)L; { const int q = nwg / NXCD, r = nwg % NXCD, xcd = wgid % NXCD, off = wgid / NXCD; wgid = (xcd < r ? xcd * (q + 1) : r * (q + 1) + (xcd - r) * q) + off; }
        const int nig = WGM * nN, gid = wgid / nig, fm = gid * WGM, gsz = (nM - fm) < WGM ? (nM - fm) : WGM;
        u.pm = fm + ((wgid % nig) % gsz); u.pn = (wgid % nig) / gsz; return true;
    }
    __device__ __forceinline__ void a_ready(const Unit&) const {}
    __device__ __forceinline__ void done(const Unit&) const {}
};

__device__ __forceinline__ unsigned cvt_pk_bf16(float lo, float hi) { unsigned r; asm volatile("v_cvt_pk_bf16_f32 %0, %1, %2" : "=v"(r) : "v"(lo), "v"(hi)); return r; }
typedef float f32x2 __attribute__((ext_vector_type(2)));
typedef _Float16 h16x2 __attribute__((ext_vector_type(2)));
__device__ __forceinline__ float bf_lo(unsigned w) { return __uint_as_float(w << 16); }
__device__ __forceinline__ float bf_hi(unsigned w) { return __uint_as_float(w & 0xffff0000u); }

struct EpiProj {
    static constexpr bool PERM = true, AFTER_DRAIN = false;
    bf16_t* qkv; bf16_t* ubuf; const unsigned* rope; float qscale;
    __device__ __forceinline__ void operator()(const f32x4 (&acc)[2][2][4][2], const Unit& u, int wr, int wc, int fr, int fq) const {
        const int row0 = u.pm * BM + wr * 64 + fr;
        const int colt = u.pn * BM + wc * 32 + 8 * fq;
#pragma unroll
        for (int ai = 0; ai < 2; ++ai)
#pragma unroll
            for (int m = 0; m < 4; ++m) {
                const int r = row0 + ai * HALF + m * 16;
#pragma unroll
                for (int bj = 0; bj < 2; ++bj) {
                    const int c0 = colt + bj * HALF;
                    f32x4 v0 = acc[ai][bj][m][0], v1 = acc[ai][bj][m][1];
                    if (u.pn < 4) {
                        const int i0 = (c0 & 63) >> 1;
                        const u32x4 rp = *(const u32x4*)(rope + (size_t)r * 32 + i0);
                        const float sc = (u.pn < 2) ? qscale : 1.0f;
                        h16x2 cs; float c, s, a, b;
                        { const unsigned wv = rp[0]; cs = __builtin_bit_cast(h16x2, wv); } c = (float)cs.x * sc; s = (float)cs.y * sc; a = v0[0]; b = v0[1]; v0[0] = a * c - b * s; v0[1] = a * s + b * c;
                        { const unsigned wv = rp[1]; cs = __builtin_bit_cast(h16x2, wv); } c = (float)cs.x * sc; s = (float)cs.y * sc; a = v0[2]; b = v0[3]; v0[2] = a * c - b * s; v0[3] = a * s + b * c;
                        { const unsigned wv = rp[2]; cs = __builtin_bit_cast(h16x2, wv); } c = (float)cs.x * sc; s = (float)cs.y * sc; a = v1[0]; b = v1[1]; v1[0] = a * c - b * s; v1[1] = a * s + b * c;
                        { const unsigned wv = rp[3]; cs = __builtin_bit_cast(h16x2, wv); } c = (float)cs.x * sc; s = (float)cs.y * sc; a = v1[2]; b = v1[3]; v1[2] = a * c - b * s; v1[3] = a * s + b * c;
                    }
                    u32x4 w; w.x = cvt_pk_bf16(v0[0], v0[1]); w.y = cvt_pk_bf16(v0[2], v0[3]); w.z = cvt_pk_bf16(v1[0], v1[1]); w.w = cvt_pk_bf16(v1[2], v1[3]);
                    if (u.pn < 6) { *(u32x4*)(qkv + (size_t)r * 1536 + c0) = w; }
                    else { const int ch = c0 - 1536, g = ch >> 4, n0 = ch & 15, b = r >> 11, s = r & 2047;
                           *(u32x4*)(ubuf + ((((size_t)b * 32 + g) * 2048 + s) << 4) + n0) = w; }
                }
            }
    }
};
struct EpiGlu {
    static constexpr bool PERM = true, AFTER_DRAIN = false;
    const bf16_t* yg; bf16_t* out; const float* bias;
    __device__ __forceinline__ void operator()(const f32x4 (&acc)[2][2][4][2], const Unit& u, int wr, int wc, int fr, int fq) const {
        const int row0 = u.pm * BM + wr * 64 + fr;
        const int colt = u.pn * BM + wc * 32 + 8 * fq;
#pragma unroll
        for (int bj = 0; bj < 2; ++bj) {
            const int c0 = colt + bj * HALF;
            const f32x4 b0 = *(const f32x4*)(bias + c0), b1 = *(const f32x4*)(bias + c0 + 4);
#pragma unroll
            for (int ai = 0; ai < 2; ++ai)
#pragma unroll
                for (int m = 0; m < 4; ++m) {
                    const size_t off = (size_t)(row0 + ai * HALF + m * 16) * 512 + c0;
                    const u32x4 y = *(const u32x4*)(yg + off);
                    const f32x4 z0 = acc[ai][bj][m][0] + b0, z1 = acc[ai][bj][m][1] + b1;
                    float o[8];
                    o[0] = bf_lo(y.x) / (1.f + __expf(-z0[0])); o[1] = bf_hi(y.x) / (1.f + __expf(-z0[1]));
                    o[2] = bf_lo(y.y) / (1.f + __expf(-z0[2])); o[3] = bf_hi(y.y) / (1.f + __expf(-z0[3]));
                    o[4] = bf_lo(y.z) / (1.f + __expf(-z1[0])); o[5] = bf_hi(y.z) / (1.f + __expf(-z1[1]));
                    o[6] = bf_lo(y.w) / (1.f + __expf(-z1[2])); o[7] = bf_hi(y.w) / (1.f + __expf(-z1[3]));
                    u32x4 w; w.x = cvt_pk_bf16(o[0], o[1]); w.y = cvt_pk_bf16(o[2], o[3]); w.z = cvt_pk_bf16(o[4], o[5]); w.w = cvt_pk_bf16(o[6], o[7]);
                    *(u32x4*)(out + off) = w;
                }
        }
    }
};
struct EpiRes {
    static constexpr bool PERM = false, AFTER_DRAIN = false;
    const float* base; float* out; const float* bias; float alpha;
    __device__ __forceinline__ void operator()(const f32x4 (&acc)[2][2][4][2], const Unit& u, int wr, int wc, int fr, int fq) const {
        const int row0 = u.pm * BM + wr * 64 + fr, col0 = u.pn * BM + wc * 32 + 4 * fq;
        f32x4 bv[2][2];
#pragma unroll
        for (int bj = 0; bj < 2; ++bj)
#pragma unroll
            for (int n = 0; n < 2; ++n) bv[bj][n] = *(const f32x4*)(bias + col0 + bj * HALF + n * 16);
#pragma unroll
        for (int ai = 0; ai < 2; ++ai)
#pragma unroll
            for (int m = 0; m < 4; ++m) { const size_t off = (size_t)(row0 + ai * HALF + m * 16) * 1024 + col0;
#pragma unroll
                for (int bj = 0; bj < 2; ++bj)
#pragma unroll
                    for (int n = 0; n < 2; ++n) { const f32x4 hv = *(const f32x4*)(base + off + bj * HALF + n * 16);
                        *(f32x4*)(out + off + bj * HALF + n * 16) = hv * alpha + acc[ai][bj][m][n] + bv[bj][n]; } }
    }
};
struct EpiFF1 {
    static constexpr bool PERM = true, AFTER_DRAIN = false;
    bf16_t* out; const float* bias;
    __device__ __forceinline__ void operator()(const f32x4 (&acc)[2][2][4][2], const Unit& u, int wr, int wc, int fr, int fq) const {
        const int row0 = u.pm * BM + wr * 64 + fr;
        const int colt = u.pn * BM + wc * 32 + 8 * fq;
#pragma unroll
        for (int bj = 0; bj < 2; ++bj) {
            const int c0 = colt + bj * HALF;
            const f32x4 b0 = *(const f32x4*)(bias + c0), b1 = *(const f32x4*)(bias + c0 + 4);
#pragma unroll
            for (int ai = 0; ai < 2; ++ai)
#pragma unroll
                for (int m = 0; m < 4; ++m) {
                    const size_t off = (size_t)(row0 + ai * HALF + m * 16) * 4096 + c0;
                    f32x4 z0 = acc[ai][bj][m][0] + b0, z1 = acc[ai][bj][m][1] + b1;
#pragma unroll
                    for (int j = 0; j < 4; ++j) { const float a = fmaxf(z0[j], 0.f), b = fmaxf(z1[j], 0.f); z0[j] = a * a; z1[j] = b * b; }
                    u32x4 w; w.x = cvt_pk_bf16(z0[0], z0[1]); w.y = cvt_pk_bf16(z0[2], z0[3]); w.z = cvt_pk_bf16(z1[0], z1[1]); w.w = cvt_pk_bf16(z1[2], z1[3]);
                    *(u32x4*)(out + off) = w;
                }
        }
    }
};

template <class Epi, class Sched, bool ALIGN_EPI = false, bool SP2 = false>
__device__ __forceinline__ void gemm_phase(PG8_LAS unsigned char* lds, const Gemm g, const Sched& S, const Epi& E) {
    int tid_o = threadIdx.x; asm volatile("" : "+v"(tid_o));
    const int tid = tid_o, wid = __builtin_amdgcn_readfirstlane(tid >> 6), lane = tid & 63, wr = wid >> 2, wc = wid & 3, fr = lane & 15, fq = lane >> 4;
    const int K = g.K, nt = K / BK;
    unsigned voffA[2], voffB[2];
#pragma unroll
    for (int i = 0; i < 2; ++i) { int R, C; stage_rc(tid * 16 + i * 8192, R, C); const int Rb = Epi::PERM ? ((R & ~31) + perm32(R & 31)) : R;
        voffA[i] = (unsigned)(R * K + C) * 2u; voffB[i] = (unsigned)(Rb * K + C) * 2u; }
    const size_t kstep = (size_t)(BK * 2);
    const size_t hstep = (size_t)HALF * K * 2;
    const size_t tstep = 2 * hstep;
    const unsigned ldsw = (unsigned)wid * 1024u;
    const int aoff = lds_byte(wr * 64 + fr, fq * 8), boff = lds_byte(wc * 32 + fr, fq * 8);
#define PG8_SA(b, h) (((b) * 2 + (h)) * HTB)
#define PG8_SB(b, h) ((4 + (b) * 2 + (h)) * HTB)
#define PG8_STAGE(bufoff, gbase, voff) do { _Pragma("unroll") for (int _i = 0; _i < 2; ++_i) \
        __builtin_amdgcn_global_load_lds((const unsigned*)((const char*)(gbase) + (voff)[_i]), (PG8_LAS unsigned*)(lds + (bufoff) + ldsw + _i * 8192), 16, 0, 0); } while (0)
#define PG8_LDA(dst, b, h) do { _Pragma("unroll") for (int m = 0; m < 4; ++m) _Pragma("unroll") for (int k = 0; k < 2; ++k) dst[m][k] = *(const PG8_LAS bf16x8*)(lds + PG8_SA(b, h) + aoff + m * 2048 + k * 1024); } while (0)
#define PG8_LDB(dst, b, h) do { _Pragma("unroll") for (int n = 0; n < 2; ++n) _Pragma("unroll") for (int k = 0; k < 2; ++k) dst[n][k] = *(const PG8_LAS bf16x8*)(lds + PG8_SB(b, h) + boff + n * 2048 + k * 1024); } while (0)
#define PG8_MMA(ai, bj, At, Bt) do { __builtin_amdgcn_s_setprio(1); _Pragma("unroll") for (int m = 0; m < 4; ++m) _Pragma("unroll") for (int n = 0; n < 2; ++n) _Pragma("unroll") for (int k = 0; k < 2; ++k) \
        acc[ai][bj][m][n] = __builtin_amdgcn_mfma_f32_16x16x32_bf16(Bt[n][k], At[m][k], acc[ai][bj][m][n], 0, 0, 0); __builtin_amdgcn_s_setprio(0); } while (0)
#define PG8_WAIT_V(n) asm volatile("s_waitcnt vmcnt(" #n ")" ::: "memory")
#define PG8_WAIT_L(n) asm volatile("s_waitcnt lgkmcnt(" #n ")" ::: "memory")
#define PG8_BAR __builtin_amdgcn_s_barrier()
#define PG8_SCHED __builtin_amdgcn_sched_barrier(0)
    Unit cur, nxt; int ui = 0;
    if (!S.next(0, cur)) return;
    f32x4 acc[2][2][4][2];
#pragma unroll
    for (int a = 0; a < 2; ++a)
#pragma unroll
        for (int b = 0; b < 2; ++b)
#pragma unroll
            for (int m = 0; m < 4; ++m)
#pragma unroll
                for (int n = 0; n < 2; ++n) acc[a][b][m][n] = (f32x4){0.f, 0.f, 0.f, 0.f};
    bf16x8 At[4][2], B0[2][2], B1[2][2];
    const char* cA = (const char*)g.A + (size_t)cur.pm * tstep; const char* cB = (const char*)g.Bt + (size_t)cur.pn * tstep;
    S.a_ready(cur);
    if constexpr (SP2) {
        PG8_STAGE(PG8_SB(0, 0), cB, voffB); PG8_STAGE(PG8_SB(0, 1), cB + hstep, voffB); PG8_STAGE(PG8_SA(0, 0), cA, voffA); PG8_STAGE(PG8_SA(0, 1), cA + hstep, voffA);
        if (wr == 1) PG8_BAR;
        PG8_WAIT_V(2); PG8_BAR;
        PG8_STAGE(PG8_SB(1, 0), cB + kstep, voffB); PG8_STAGE(PG8_SA(1, 0), cA + kstep, voffA); PG8_STAGE(PG8_SB(1, 1), cB + hstep + kstep, voffB);
        PG8_WAIT_V(6); PG8_BAR;
    } else {
        PG8_STAGE(PG8_SB(0, 0), cB, voffB); PG8_STAGE(PG8_SA(0, 0), cA, voffA); PG8_STAGE(PG8_SB(0, 1), cB + hstep, voffB); PG8_STAGE(PG8_SA(0, 1), cA + hstep, voffA);
        if (wr == 1) PG8_BAR;
        PG8_WAIT_V(4); PG8_BAR;
        PG8_STAGE(PG8_SB(1, 0), cB + kstep, voffB); PG8_STAGE(PG8_SA(1, 0), cA + kstep, voffA); PG8_STAGE(PG8_SB(1, 1), cB + hstep + kstep, voffB);
        PG8_WAIT_V(6); PG8_BAR;
    }
    for (;;) {
        const bool has_next = S.next(ui + 1, nxt);
        const char* nA = has_next ? (const char*)g.A + (size_t)nxt.pm * tstep : cA; const char* nB = has_next ? (const char*)g.Bt + (size_t)nxt.pn * tstep : cB;
        for (int t = 0; t < nt; t += 2) {
            const bool last = (t == nt - 2);
            const char* a1 = cA + (size_t)(t + 1) * kstep;
            const char* a2 = last ? nA : cA + (size_t)(t + 2) * kstep; const char* b2 = last ? nB : cB + (size_t)(t + 2) * kstep;
            const char* a3 = a2 + kstep; const char* b3 = b2 + kstep;
            if (last && has_next) S.a_ready(nxt);
            if constexpr (SP2) {
            PG8_LDB(B0, 0, 0); PG8_LDB(B1, 0, 1); PG8_SCHED; PG8_LDA(At, 0, 0); PG8_STAGE(PG8_SA(1, 1), a1 + hstep, voffA);
            PG8_WAIT_V(8); PG8_WAIT_L(0); PG8_BAR; PG8_MMA(0, 0, At, B0); PG8_MMA(0, 1, At, B1); PG8_BAR; PG8_SCHED;
            PG8_LDA(At, 0, 1); PG8_STAGE(PG8_SB(0, 0), b2, voffB); PG8_STAGE(PG8_SB(0, 1), b2 + hstep, voffB); PG8_STAGE(PG8_SA(0, 0), a2, voffA);
            PG8_WAIT_V(8); PG8_WAIT_L(0); PG8_BAR; PG8_MMA(1, 0, At, B0); PG8_MMA(1, 1, At, B1); PG8_BAR; PG8_SCHED;
            PG8_LDB(B0, 1, 0); PG8_LDB(B1, 1, 1); PG8_SCHED; PG8_LDA(At, 1, 0); PG8_STAGE(PG8_SA(0, 1), a2 + hstep, voffA);
            PG8_WAIT_V(8); PG8_WAIT_L(0); PG8_BAR; PG8_MMA(0, 0, At, B0); PG8_MMA(0, 1, At, B1); PG8_BAR; PG8_SCHED;
            PG8_LDA(At, 1, 1); PG8_STAGE(PG8_SB(1, 0), b3, voffB); PG8_STAGE(PG8_SB(1, 1), b3 + hstep, voffB); PG8_STAGE(PG8_SA(1, 0), a3, voffA);
            PG8_WAIT_V(8); PG8_WAIT_L(0); PG8_BAR; PG8_MMA(1, 0, At, B0); PG8_MMA(1, 1, At, B1); PG8_BAR; PG8_SCHED;
            } else {
            PG8_LDB(B0, 0, 0); PG8_SCHED; PG8_LDA(At, 0, 0); PG8_STAGE(PG8_SA(1, 1), a1 + hstep, voffA);
            PG8_WAIT_L(8); PG8_BAR; PG8_WAIT_L(0); PG8_MMA(0, 0, At, B0); PG8_BAR; PG8_SCHED;
            PG8_LDB(B1, 0, 1); PG8_STAGE(PG8_SB(0, 0), b2, voffB);
            PG8_BAR; PG8_WAIT_L(0); PG8_MMA(0, 1, At, B1); PG8_BAR;
            PG8_LDA(At, 0, 1); PG8_STAGE(PG8_SA(0, 0), a2, voffA);
            PG8_BAR; PG8_WAIT_L(0); PG8_MMA(1, 0, At, B0); PG8_BAR; PG8_SCHED;
            PG8_STAGE(PG8_SB(0, 1), b2 + hstep, voffB);
            PG8_WAIT_V(6); PG8_BAR; PG8_MMA(1, 1, At, B1); PG8_BAR;
            PG8_LDB(B0, 1, 0); PG8_SCHED; PG8_LDA(At, 1, 0); PG8_STAGE(PG8_SA(0, 1), a2 + hstep, voffA);
            PG8_WAIT_L(8); PG8_BAR; PG8_WAIT_L(0); PG8_MMA(0, 0, At, B0); PG8_BAR; PG8_SCHED;
            PG8_LDB(B1, 1, 1); PG8_STAGE(PG8_SB(1, 0), b3, voffB);
            PG8_BAR; PG8_WAIT_L(0); PG8_MMA(0, 1, At, B1); PG8_BAR;
            PG8_LDA(At, 1, 1); PG8_STAGE(PG8_SA(1, 0), a3, voffA);
            PG8_BAR; PG8_WAIT_L(0); PG8_MMA(1, 0, At, B0); PG8_BAR; PG8_SCHED;
            PG8_STAGE(PG8_SB(1, 1), b3 + hstep, voffB);
            PG8_WAIT_V(6); PG8_BAR; PG8_MMA(1, 1, At, B1); PG8_BAR;
            }
        }
        if constexpr (ALIGN_EPI) { if (wr == 0) PG8_BAR; }
        if constexpr (!Epi::AFTER_DRAIN) { E(acc, cur, wr, wc, fr, fq); S.done(cur); }
        if (!has_next) break;
#pragma unroll
        for (int a = 0; a < 2; ++a)
#pragma unroll
            for (int b = 0; b < 2; ++b)
#pragma unroll
                for (int m = 0; m < 4; ++m)
#pragma unroll
                    for (int n = 0; n < 2; ++n) acc[a][b][m][n] = (f32x4){0.f, 0.f, 0.f, 0.f};
        cur = nxt; cA = nA; cB = nB; ++ui;
        if constexpr (ALIGN_EPI) { if (wr == 1) PG8_BAR; }
    }
    PG8_WAIT_V(0);
    if constexpr (!ALIGN_EPI) { if (wr == 0) PG8_BAR; }
    PG8_BAR;
    if constexpr (Epi::AFTER_DRAIN) { E.fused(acc, cur, wr, wc, fr, fq, lds, wid, lane); S.done(cur); }
#undef PG8_SA
#undef PG8_SB
#undef PG8_STAGE
#undef PG8_LDA
#undef PG8_LDB
#undef PG8_MMA
#undef PG8_WAIT_V
#undef PG8_WAIT_L
#undef PG8_BAR
#undef PG8_SCHED
}
}
#define LAS __attribute__((address_space(3)))
typedef unsigned short bf16;
typedef unsigned v4u __attribute__((ext_vector_type(4)));
typedef unsigned v2u __attribute__((ext_vector_type(2)));
typedef float f32x4 __attribute__((ext_vector_type(4)));
typedef short bf16x8 __attribute__((ext_vector_type(8)));
typedef short s16x4 __attribute__((ext_vector_type(4)));
typedef short v4i16_t __attribute__((ext_vector_type(4)));

constexpr int NB = 32, SEQ = 2048, T = NB * SEQ, D = 1024, NIN = 2048, AW = 512, SW = 512, FF = 4096, NL = 4, NH = 8;
constexpr int NG = 32, GD = 16, NST = 64;
constexpr float LN_EPS = 1e-5f, RMS_EPS = 1e-6f;
constexpr float DN_ALPHA = 1.681792830507429f;
constexpr float QSCALE = 0.125f * 1.4426950408889634f;
constexpr size_t MiB = 1u << 20;
constexpr size_t WS_WIN = 0;
constexpr size_t WS_WGLU = WS_WIN + 16 * MiB;
constexpr size_t WS_WOUT = WS_WGLU + 2 * MiB;
constexpr size_t WS_WFF1 = WS_WOUT + 8 * MiB;
constexpr size_t WS_WFF2 = WS_WFF1 + 32 * MiB;
constexpr size_t WS_HT = WS_WFF2 + 32 * MiB;
constexpr size_t WS_W3 = WS_HT + 8 * MiB;
constexpr size_t WS_LAM = WS_W3 + 24 * MiB;
constexpr size_t WS_ROPE = WS_LAM + 1 * MiB;
constexpr size_t WS_HB = WS_ROPE + 8 * MiB;
constexpr size_t WS_R1 = WS_HB + 128 * MiB;
constexpr size_t WS_QKV = WS_R1;
constexpr size_t WS_UB = WS_QKV + 192 * MiB;
constexpr size_t WS_OB = WS_UB + 64 * MiB;
constexpr size_t WS_YG = WS_OB + 192 * MiB;
constexpr size_t WS_HID = WS_R1;
constexpr size_t WS_R2 = WS_R1 + 512 * MiB;
constexpr size_t WS_LSE = WS_R2;
constexpr size_t WS_GATED = WS_LSE + 6 * MiB;
constexpr size_t WS_MIXED = WS_GATED + 64 * MiB;
constexpr size_t WS_END = WS_MIXED + 128 * MiB;
static_assert(WS_YG + 64 * MiB == WS_R2, "R1 map");
static_assert(WS_END <= 1024 * MiB, "workspace budget");

constexpr int LDS_BYTES = 139264;

struct Args {
    const float* x; const int* pos; const float* w_in; const float* attn_gain; const float* ssm_gain; const float* a_re; const float* a_im; const float* log_dt;
    const float* b_re; const float* b_im; const float* c_re; const float* c_im; const float* dsk; const float* w_glu; const float* b_glu; const float* w_out; const float* b_out;
    const float* ln1_g; const float* ln1_b; const float* w_ff1; const float* b_ff1; const float* w_ff2; const float* b_ff2; const float* ln2_g; const float* ln2_b;
    float* out; unsigned char* ws;
};

__device__ __forceinline__ unsigned f2bf(float f) { unsigned u = __builtin_bit_cast(unsigned, f); return (u + 0x7fffu + ((u >> 16) & 1u)) >> 16; }
__device__ __forceinline__ unsigned pk2(float lo, float hi) { return f2bf(lo) | (f2bf(hi) << 16); }
__device__ __forceinline__ float bflo(unsigned w) { return __uint_as_float(w << 16); }
__device__ __forceinline__ float bfhi(unsigned w) { return __uint_as_float(w & 0xffff0000u); }
__device__ __forceinline__ float wave_sum(float v) {
#pragma unroll
    for (int o = 1; o < 64; o <<= 1) v += __shfl_xor(v, o);
    return v;
}
#define LDS_WAIT() asm volatile("s_waitcnt lgkmcnt(0)" ::: "memory")

template <bool PERMQ>
__device__ __forceinline__ void p0_transpose_item(const float* W, int K, int N, bf16* WT, LAS float* scr, int item, int lane) {
    const int nblk = N / 32, kb = item / nblk, nb = item % nblk, k0 = 64 * kb, n0 = 32 * nb;
#pragma unroll 8
    for (int i = 0; i < 32; ++i) { const int kk = 2 * i + (lane >> 5); scr[kk * 33 + (lane & 31)] = W[(size_t)(k0 + kk) * N + n0 + (lane & 31)]; }
    LDS_WAIT();
    const int c = lane & 7;
#pragma unroll
    for (int j = 0; j < 4; ++j) { const int n = (lane >> 3) + 8 * j; const LAS float* s = scr + (8 * c) * 33 + n;
        v4u o; o.x = pk2(s[0 * 33], s[1 * 33]); o.y = pk2(s[2 * 33], s[3 * 33]); o.z = pk2(s[4 * 33], s[5 * 33]); o.w = pk2(s[6 * 33], s[7 * 33]);
        int nd = n0 + n;
        if (PERMQ && nd < 1024) { const int i6 = nd & 63; nd = (nd & ~63) + 2 * (i6 & 31) + (i6 >> 5); }
        *(v4u*)(WT + (size_t)nd * K + k0 + 8 * c) = o; }
    LDS_WAIT();
}

__device__ void ssm_setup(const Args& A, LAS unsigned char* lds, int lg, int tid) {
    const int l = lg >> 5, g = lg & 31;
    LAS float* lamr = (LAS float*)lds;
    LAS float* lami = lamr + 17 * 64;
    LAS float* bbr = lami + 17 * 64;
    LAS float* bbi = bbr + 1024;
    LAS float* ccr = bbi + 1024;
    LAS float* cci = ccr + 1024;
    LAS float* ktab = cci + 1024;
    const float* a_re = A.a_re + (size_t)lg * 64; const float* a_im = A.a_im + (size_t)lg * 64;
    const float dt = expf(A.log_dt[lg]);
    for (int e = tid; e < 17 * 64; e += 512) { const int tau = e >> 6, p = e & 63; const float mg = expf(a_re[p] * dt * (float)tau), an = a_im[p] * dt * (float)tau; lamr[e] = mg * cosf(an); lami[e] = mg * sinf(an); }
    for (int e = tid; e < 1024; e += 512) { const int p = e >> 4;
        const float ar = a_re[p], ai = a_im[p], mg = expf(ar * dt), an = ai * dt, lbr = mg * cosf(an), lbi = mg * sinf(an);
        const float den = ar * ar + ai * ai, nr = lbr - 1.0f, ni = lbi, cr = (nr * ar + ni * ai) / den, ci = (ni * ar - nr * ai) / den;
        const float br = A.b_re[(size_t)lg * 1024 + e], bi = A.b_im[(size_t)lg * 1024 + e];
        bbr[e] = cr * br - ci * bi; bbi[e] = cr * bi + ci * br;
        ccr[e] = A.c_re[(size_t)lg * 1024 + e]; cci[e] = A.c_im[(size_t)lg * 1024 + e]; }
    __syncthreads();
    for (int e = tid; e < 4096; e += 512) { const int tau = e >> 8, n = (e >> 4) & 15, m = e & 15; float acc = 0.f;
        for (int p = 0; p < 64; ++p) { const float lr = lamr[tau * 64 + p], li = lami[tau * 64 + p], br = bbr[p * 16 + m], bi = bbi[p * 16 + m];
            const float er = lr * br - li * bi, ei = lr * bi + li * br; acc += ccr[n * 64 + p] * er - cci[n * 64 + p] * ei; }
        if (tau == 0 && n == m) acc += A.dsk[(size_t)lg * 16 + n];
        ktab[e] = acc; }
    __syncthreads();
    bf16* Ht = (bf16*)(A.ws + WS_HT) + (size_t)lg * 128 * 256;
    for (int ch = tid; ch < 128 * 32; ch += 512) { const int np = ch >> 5, k0 = (ch & 31) * 8, p = np & 63, im = np >> 6; float v[8];
#pragma unroll
        for (int j = 0; j < 8; ++j) { const int k = k0 + j, s = k >> 4, m = k & 15; const float lr = lamr[(15 - s) * 64 + p], li = lami[(15 - s) * 64 + p], br = bbr[p * 16 + m], bi = bbi[p * 16 + m];
            v[j] = im ? (lr * bi + li * br) : (lr * br - li * bi); }
        v4u o; o.x = pk2(v[0], v[1]); o.y = pk2(v[2], v[3]); o.z = pk2(v[4], v[5]); o.w = pk2(v[6], v[7]);
        *(v4u*)(Ht + (size_t)np * 256 + k0) = o; }
    bf16* W3 = (bf16*)(A.ws + WS_W3) + (size_t)lg * 256 * 384;
    for (int ch = tid; ch < 256 * 48; ch += 512) { const int col = ch / 48, k0 = (ch % 48) * 8, t = col >> 4, n = col & 15; float v[8];
#pragma unroll
        for (int j = 0; j < 8; ++j) { const int k = k0 + j;
            if (k < 256) { const int s = k >> 4, m = k & 15; v[j] = (s <= t) ? ktab[(t - s) * 256 + n * 16 + m] : 0.f; }
            else { const int q = k - 256, p = q & 63, im = q >> 6; const float lr = lamr[(t + 1) * 64 + p], li = lami[(t + 1) * 64 + p], cr = ccr[n * 64 + p], ci = cci[n * 64 + p];
                v[j] = im ? -(cr * li + ci * lr) : (cr * lr - ci * li); } }
        v4u o; o.x = pk2(v[0], v[1]); o.y = pk2(v[2], v[3]); o.z = pk2(v[4], v[5]); o.w = pk2(v[6], v[7]);
        *(v4u*)(W3 + (size_t)col * 384 + k0) = o; }
    float* lam = (float*)(A.ws + WS_LAM) + (size_t)lg * 128;
    if (tid < 64) { lam[tid * 2] = lamr[16 * 64 + tid]; lam[tid * 2 + 1] = lami[16 * 64 + tid]; }
    __syncthreads();
}

__device__ void phase0(const Args& A, LAS unsigned char* lds, int tid, int lane, int wave, int G, int c) {
    LAS float* scr = (LAS float*)(lds + wave * 8448);
    const int gw = c * 8 + wave, NGW = G * 8;
    constexpr int I_IN = (D / 64) * (NIN / 32), I_GLU = (SW / 64) * (SW / 32), I_OUT = (D / 64) * (D / 32), I_F1 = (D / 64) * (FF / 32), I_F2 = (FF / 64) * (D / 32);
    constexpr int PER_L = I_IN + I_GLU + I_OUT + I_F1 + I_F2;
    for (int it = gw; it < NL * PER_L; it += NGW) {
        const int l = it / PER_L; int r = it % PER_L;
        if (r < I_IN) { p0_transpose_item<true>(A.w_in + (size_t)l * D * NIN, D, NIN, (bf16*)(A.ws + WS_WIN) + (size_t)l * NIN * D, scr, r, lane); continue; } r -= I_IN;
        if (r < I_GLU) { p0_transpose_item<false>(A.w_glu + (size_t)l * SW * SW, SW, SW, (bf16*)(A.ws + WS_WGLU) + (size_t)l * SW * SW, scr, r, lane); continue; } r -= I_GLU;
        if (r < I_OUT) { p0_transpose_item<false>(A.w_out + (size_t)l * D * D, D, D, (bf16*)(A.ws + WS_WOUT) + (size_t)l * D * D, scr, r, lane); continue; } r -= I_OUT;
        if (r < I_F1) { p0_transpose_item<false>(A.w_ff1 + (size_t)l * D * FF, D, FF, (bf16*)(A.ws + WS_WFF1) + (size_t)l * FF * D, scr, r, lane); continue; } r -= I_F1;
        p0_transpose_item<false>(A.w_ff2 + (size_t)l * FF * D, FF, D, (bf16*)(A.ws + WS_WFF2) + (size_t)l * D * FF, scr, r, lane);
    }
    { const size_t nth = (size_t)G * 512, gt = (size_t)c * 512 + tid; bf16* hb = (bf16*)(A.ws + WS_HB);
      for (size_t i = gt; i < (size_t)T * D / 8; i += nth) { const f32x4 a = *(const f32x4*)(A.x + i * 8), b = *(const f32x4*)(A.x + i * 8 + 4);
          v4u o; o.x = pk2(a[0], a[1]); o.y = pk2(a[2], a[3]); o.z = pk2(b[0], b[1]); o.w = pk2(b[2], b[3]); *(v4u*)(hb + i * 8) = o; }
      unsigned* rope = (unsigned*)(A.ws + WS_ROPE);
      for (size_t i = gt; i < (size_t)T * 32; i += nth) { const int t = (int)(i >> 5), j = (int)(i & 31);
          const float invf = exp2f(-(float)j * (2.0f / 64.0f) * 13.287712379549449f), ang = (float)A.pos[t] * invf;
          pg8::h16x2 cs; cs.x = (_Float16)cosf(ang); cs.y = (_Float16)sinf(ang); rope[i] = __builtin_bit_cast(unsigned, cs); } }
    __syncthreads();
    for (int lg = c; lg < NL * NG; lg += G) ssm_setup(A, lds, lg, tid);
}
constexpr int KV_STRIDE = 144;
constexpr int ATT_K_OFF = 0, ATT_V_OFF = 256 * KV_STRIDE;
__device__ __forceinline__ s16x4 vtr(const LAS unsigned char* p) { return __builtin_bit_cast(s16x4, __builtin_amdgcn_ds_read_tr16_b64_v4i16((LAS v4i16_t*)p)); }

__device__ void attn_item(LAS unsigned char* lds, const bf16* qkv, bf16* ob, float* lse, int bh, int it, int tid, int lane, int wave) {
    const int b = bh >> 3, h = bh & 7, br = it >> 4, x = it & 15;
    int d, r, n;
    if (br == 0) { d = 1; r = 0; n = x; } else if (br == 1) { d = 4; r = x & 3; n = x >> 2; } else { d = 16; r = x; n = 0; }
    const int ksub0 = (n - 1) * 128;
    const bf16* base = qkv + (size_t)b * SEQ * 1536 + h * 64;
    __syncthreads();
#pragma unroll
    for (int i = 0; i < 4; ++i) {
        const int ch = tid + 512 * i, j = ch >> 3, cc = ch & 7, sub = ksub0 + j;
        v4u kv = (v4u){0u, 0u, 0u, 0u}, vv = (v4u){0u, 0u, 0u, 0u};
        if (sub >= 0) { const bf16* p = base + (size_t)(sub * d + r) * 1536 + cc * 8; kv = *(const v4u*)(p + 512); vv = *(const v4u*)(p + 1024); }
        *(LAS v4u*)(lds + ATT_K_OFF + j * KV_STRIDE + cc * 16) = kv;
        *(LAS v4u*)(lds + ATT_V_OFF + j * KV_STRIDE + cc * 16) = vv;
    }
    const int qi = lane & 15, grp = lane >> 4;
    const int iq = 16 * wave + qi;
    const int qpos = ((n * 128 + iq) * d + r);
    bf16x8 qf[2];
    { const bf16* qp = base + (size_t)qpos * 1536 + grp * 8; qf[0] = *(const bf16x8*)qp; qf[1] = *(const bf16x8*)(qp + 32); }
    __syncthreads();
    float sc[9][4];
    float mx = -INFINITY;
#pragma unroll
    for (int jj = 0; jj < 9; ++jj) {
        const int jt = wave + jj;
        if (n == 0 && jt < 8) {
#pragma unroll
            for (int q = 0; q < 4; ++q) sc[jj][q] = -INFINITY;
        } else {
            const LAS unsigned char* kp = lds + ATT_K_OFF + (16 * jt + qi) * KV_STRIDE + grp * 16;
            const bf16x8 k0 = *(const LAS bf16x8*)kp, k1 = *(const LAS bf16x8*)(kp + 64);
            f32x4 a = (f32x4){0.f, 0.f, 0.f, 0.f};
            a = __builtin_amdgcn_mfma_f32_16x16x32_bf16(k0, qf[0], a, 0, 0, 0);
            a = __builtin_amdgcn_mfma_f32_16x16x32_bf16(k1, qf[1], a, 0, 0, 0);
#pragma unroll
            for (int q = 0; q < 4; ++q) { const int j = 16 * jt + 4 * grp + q; const bool ok = (j >= iq) && (j <= iq + 128) && (ksub0 + j >= 0);
                const float s = ok ? a[q] : -INFINITY; sc[jj][q] = s; mx = fmaxf(mx, s); }
        }
    }
    mx = fmaxf(mx, __shfl_xor(mx, 16)); mx = fmaxf(mx, __shfl_xor(mx, 32));
    float den = 0.f;
#pragma unroll
    for (int jj = 0; jj < 9; ++jj)
#pragma unroll
        for (int q = 0; q < 4; ++q) { const float p = exp2f(sc[jj][q] - mx); sc[jj][q] = p; den += p; }
    den += __shfl_xor(den, 16); den += __shfl_xor(den, 32);
    f32x4 o[4];
#pragma unroll
    for (int et = 0; et < 4; ++et) o[et] = (f32x4){0.f, 0.f, 0.f, 0.f};
    const int li = lane & 15;
    const LAS unsigned char* vbase = lds + ATT_V_OFF + (4 * grp + (li >> 2)) * KV_STRIDE + (li & 3) * 8;
#pragma unroll
    for (int pp = 0; pp < 5; ++pp) {
        const int jt0 = wave + 2 * pp, jt1 = jt0 + 1;
        if (n == 0 && jt1 < 8) continue;
        v2u plo, phi;
        plo.x = pk2(sc[2 * pp][0], sc[2 * pp][1]); plo.y = pk2(sc[2 * pp][2], sc[2 * pp][3]);
        if (pp < 4) { phi.x = pk2(sc[2 * pp + 1][0], sc[2 * pp + 1][1]); phi.y = pk2(sc[2 * pp + 1][2], sc[2 * pp + 1][3]); } else { phi.x = 0u; phi.y = 0u; }
        const bf16x8 pf = __builtin_bit_cast(bf16x8, (v4u){plo.x, plo.y, phi.x, phi.y});
        const bool hi_ok = (pp < 4);
#pragma unroll
        for (int et = 0; et < 4; ++et) {
            const s16x4 lo = vtr(vbase + (16 * jt0) * KV_STRIDE + et * 32);
            s16x4 hi = (s16x4){0, 0, 0, 0};
            if (hi_ok) hi = vtr(vbase + (16 * jt1) * KV_STRIDE + et * 32);
            const bf16x8 vf = (bf16x8){lo[0], lo[1], lo[2], lo[3], hi[0], hi[1], hi[2], hi[3]};
            o[et] = __builtin_amdgcn_mfma_f32_16x16x32_bf16(vf, pf, o[et], 0, 0, 0);
        }
    }
    const float inv = 1.0f / den;
    const size_t trow = (size_t)b * SEQ + qpos;
    bf16* op = ob + ((size_t)br * T + trow) * 512 + h * 64 + 4 * grp;
#pragma unroll
    for (int et = 0; et < 4; ++et) { v2u w; w.x = pk2(o[et][0] * inv, o[et][1] * inv); w.y = pk2(o[et][2] * inv, o[et][3] * inv); *(v2u*)(op + 16 * et) = w; }
    if (grp == 0) lse[((size_t)br * T + trow) * 8 + h] = mx + log2f(den);
}


#ifdef NAIVE_ATTN
__device__ void attn_naive(const bf16* qkv, bf16* ob, float* lse, int lane, int gw, int NGW) {
    for (int it = gw; it < T * 8; it += NGW) {
        const int t = it >> 3, h = it & 7, b = t >> 11, s = t & 2047;
        const float qv = __uint_as_float((unsigned)qkv[(size_t)t * 1536 + h * 64 + lane] << 16);
        for (int br = 0; br < 3; ++br) {
            const int d = br == 0 ? 1 : (br == 1 ? 4 : 16);
            float m = -INFINITY, den = 0.f, acc = 0.f;
            for (int j = 0; j <= 128; ++j) {
                const int sp = s - j * d; if (sp < 0) break;
                const bf16* kp = qkv + (size_t)(b * SEQ + sp) * 1536 + h * 64 + lane;
                const float kv = __uint_as_float((unsigned)kp[512] << 16), vv = __uint_as_float((unsigned)kp[1024] << 16);
                const float sc = wave_sum(qv * kv);
                const float mn = fmaxf(m, sc), corr = exp2f(m - mn), p = exp2f(sc - mn);
                den = den * corr + p; acc = acc * corr + p * vv; m = mn;
            }
            ob[((size_t)br * T + t) * 512 + h * 64 + lane] = (bf16)f2bf(acc / den);
            if (lane == 0) lse[((size_t)br * T + t) * 8 + h] = m + log2f(den);
        }
    }
}
#endif
constexpr int SSM_ROW = 528;
constexpr int SSM_U_OFF = 0, SSM_S_OFF = 128 * SSM_ROW;
__device__ void ssm_item(LAS unsigned char* lds, const bf16* ubuf, const bf16* Ht, const bf16* W3, const float* lam16, bf16* yg, int b, int g, int tid, int lane, int wave) {
    const bf16* usl = ubuf + ((size_t)b * 32 + g) * (2048 * 16);
    __syncthreads();
#pragma unroll
    for (int i = 0; i < 8; ++i) { const int ch = tid + 512 * i, row = ch >> 5, cc = ch & 31; *(LAS v4u*)(lds + SSM_U_OFF + row * SSM_ROW + cc * 16) = *(const v4u*)(usl + (size_t)ch * 8); }
    const int fr = lane & 15, grp = lane >> 4;
    {
        bf16x8 bfr[8];
#pragma unroll
        for (int kk = 0; kk < 8; ++kk) bfr[kk] = *(const bf16x8*)(Ht + (size_t)(16 * wave + fr) * 256 + kk * 32 + grp * 8);
        __syncthreads();
#pragma unroll 2
        for (int mt = 0; mt < 8; ++mt) {
            f32x4 a = (f32x4){0.f, 0.f, 0.f, 0.f};
            const LAS unsigned char* up = lds + SSM_U_OFF + (16 * mt + fr) * SSM_ROW + grp * 16;
#pragma unroll
            for (int kk = 0; kk < 8; ++kk) a = __builtin_amdgcn_mfma_f32_16x16x32_bf16(*(const LAS bf16x8*)(up + kk * 64), bfr[kk], a, 0, 0, 0);
#pragma unroll
            for (int q = 0; q < 4; ++q) *(LAS float*)(lds + SSM_S_OFF + (16 * mt + 4 * grp + q) * SSM_ROW + (16 * wave + fr) * 4) = a[q];
        }
    }
    __syncthreads();
    if (wave == 0) {
        const float lr = lam16[lane * 2], li = lam16[lane * 2 + 1];
        float xr = 0.f, xi = 0.f;
        for (int c = 0; c < 128; ++c) {
            LAS unsigned char* rowp = lds + SSM_S_OFF + c * SSM_ROW;
            const float sr = *(LAS float*)(rowp + lane * 4), si = *(LAS float*)(rowp + 256 + lane * 4);
            LDS_WAIT();
            *(LAS unsigned short*)(rowp + lane * 2) = (unsigned short)f2bf(xr);
            *(LAS unsigned short*)(rowp + 128 + lane * 2) = (unsigned short)f2bf(xi);
            asm volatile("" ::: "memory");
            const float nr = lr * xr - li * xi + sr, ni = lr * xi + li * xr + si; xr = nr; xi = ni;
        }
    }
    __syncthreads();
#pragma unroll 1
    for (int half = 0; half < 2; ++half) {
        const int nt = half ? 15 - wave : wave, nk = (nt >> 1) + 1;
        const bf16* wrow = W3 + (size_t)(16 * nt + fr) * 384 + grp * 8;
        bf16x8 bt[8], bg[4];
#pragma unroll
        for (int kk = 0; kk < 8; ++kk) bt[kk] = (kk < nk) ? *(const bf16x8*)(wrow + kk * 32) : (bf16x8){0, 0, 0, 0, 0, 0, 0, 0};
#pragma unroll
        for (int kq = 0; kq < 4; ++kq) bg[kq] = *(const bf16x8*)(wrow + 256 + kq * 32);
#pragma unroll 1
        for (int mt = 0; mt < 8; ++mt) {
            f32x4 a = (f32x4){0.f, 0.f, 0.f, 0.f};
            const LAS unsigned char* up = lds + SSM_U_OFF + (16 * mt + fr) * SSM_ROW + grp * 16;
            const LAS unsigned char* xp = lds + SSM_S_OFF + (16 * mt + fr) * SSM_ROW + grp * 16;
#pragma unroll
            for (int kk = 0; kk < 8; ++kk) if (kk < nk) a = __builtin_amdgcn_mfma_f32_16x16x32_bf16(*(const LAS bf16x8*)(up + kk * 64), bt[kk], a, 0, 0, 0);
#pragma unroll
            for (int kq = 0; kq < 4; ++kq) a = __builtin_amdgcn_mfma_f32_16x16x32_bf16(*(const LAS bf16x8*)(xp + kq * 64), bg[kq], a, 0, 0, 0);
#pragma unroll
            for (int q = 0; q < 4; ++q) { const int s = 16 * (16 * mt + 4 * grp + q) + nt; const float y = a[q];
                const float z = 1.5957691216057308f * (y + 0.044715f * y * y * y), ge = y / (1.0f + __expf(-z));
                yg[((size_t)b * SEQ + s) * 512 + 16 * g + fr] = (bf16)f2bf(ge); }
        }
    }
}


#ifdef NAIVE_SSM
__device__ void ssm_naive(const Args& A, int l, const bf16* ubuf, bf16* yg, int lane, int gw, int NGW) {
    for (int it = gw; it < NB * NG; it += NGW) {
        const int b = it >> 5, g = it & 31, lg = l * NG + g, p = lane;
        const float dt = expf(A.log_dt[lg]), ar = A.a_re[lg * 64 + p], ai = A.a_im[lg * 64 + p], mg = expf(ar * dt), an = ai * dt, lr = mg * cosf(an), li = mg * sinf(an);
        const float den = ar * ar + ai * ai, nr = lr - 1.0f, ni = li, cr_ = (nr * ar + ni * ai) / den, ci_ = (ni * ar - nr * ai) / den;
        float bbr[16], bbi[16], ccr[16], cci[16];
#pragma unroll
        for (int m = 0; m < 16; ++m) { const float br = A.b_re[(size_t)lg * 1024 + p * 16 + m], bi = A.b_im[(size_t)lg * 1024 + p * 16 + m]; bbr[m] = cr_ * br - ci_ * bi; bbi[m] = cr_ * bi + ci_ * br;
            ccr[m] = A.c_re[(size_t)lg * 1024 + m * 64 + p]; cci[m] = A.c_im[(size_t)lg * 1024 + m * 64 + p]; }
        const float dn = A.dsk[lg * 16 + (lane & 15)];
        float xr = 0.f, xi = 0.f;
        const bf16* up = ubuf + ((size_t)b * 32 + g) * (2048 * 16);
        for (int s = 0; s < SEQ; ++s) {
            const v4u u0 = *(const v4u*)(up + (size_t)s * 16), u1 = *(const v4u*)(up + (size_t)s * 16 + 8);
            float u[16];
            u[0] = bflo(u0.x); u[1] = bfhi(u0.x); u[2] = bflo(u0.y); u[3] = bfhi(u0.y); u[4] = bflo(u0.z); u[5] = bfhi(u0.z); u[6] = bflo(u0.w); u[7] = bfhi(u0.w);
            u[8] = bflo(u1.x); u[9] = bfhi(u1.x); u[10] = bflo(u1.y); u[11] = bfhi(u1.y); u[12] = bflo(u1.z); u[13] = bfhi(u1.z); u[14] = bflo(u1.w); u[15] = bfhi(u1.w);
            float bur = 0.f, bui = 0.f;
#pragma unroll
            for (int m = 0; m < 16; ++m) { bur += bbr[m] * u[m]; bui += bbi[m] * u[m]; }
            const float nxr = lr * xr - li * xi + bur, nxi = lr * xi + li * xr + bui; xr = nxr; xi = nxi;
            float yv = 0.f;
#pragma unroll
            for (int n = 0; n < 16; ++n) { const float v = wave_sum(ccr[n] * xr - cci[n] * xi); if ((lane & 15) == n) yv = v; }
            const float uu = __uint_as_float((unsigned)up[(size_t)s * 16 + (lane & 15)] << 16);
            const float y = yv + dn * uu;
            const float z = 1.5957691216057308f * (y + 0.044715f * y * y * y), ge = y / (1.0f + __expf(-z));
            if (lane < 16) yg[((size_t)b * SEQ + s) * 512 + 16 * g + lane] = (bf16)f2bf(ge);
        }
    }
}
#endif
__device__ void finalize_phase(const Args& A, int l, int lane, int gw, int NGW) {
    const bf16* ob = (const bf16*)(A.ws + WS_OB); const float* lse = (const float*)(A.ws + WS_LSE); const bf16* gated = (const bf16*)(A.ws + WS_GATED); bf16* mixed = (bf16*)(A.ws + WS_MIXED);
    const f32x4 ga0 = *(const f32x4*)(A.attn_gain + l * 512 + lane * 8), ga1 = *(const f32x4*)(A.attn_gain + l * 512 + lane * 8 + 4);
    const f32x4 gs0 = *(const f32x4*)(A.ssm_gain + l * 512 + lane * 8), gs1 = *(const f32x4*)(A.ssm_gain + l * 512 + lane * 8 + 4);
    const int head = lane >> 3;
    for (int t = gw; t < T; t += NGW) {
        const float l0 = lse[(size_t)t * 8 + head], l1 = lse[((size_t)T + t) * 8 + head], l2 = lse[((size_t)2 * T + t) * 8 + head];
        const float m = fmaxf(l0, fmaxf(l1, l2)); float w0 = exp2f(l0 - m), w1 = exp2f(l1 - m), w2 = exp2f(l2 - m); const float iw = 1.0f / (w0 + w1 + w2); w0 *= iw; w1 *= iw; w2 *= iw;
        const v4u a0 = *(const v4u*)(ob + (size_t)t * 512 + lane * 8), a1 = *(const v4u*)(ob + ((size_t)T + t) * 512 + lane * 8), a2 = *(const v4u*)(ob + ((size_t)2 * T + t) * 512 + lane * 8);
        float v[8];
        v[0] = w0 * bflo(a0.x) + w1 * bflo(a1.x) + w2 * bflo(a2.x); v[1] = w0 * bfhi(a0.x) + w1 * bfhi(a1.x) + w2 * bfhi(a2.x);
        v[2] = w0 * bflo(a0.y) + w1 * bflo(a1.y) + w2 * bflo(a2.y); v[3] = w0 * bfhi(a0.y) + w1 * bfhi(a1.y) + w2 * bfhi(a2.y);
        v[4] = w0 * bflo(a0.z) + w1 * bflo(a1.z) + w2 * bflo(a2.z); v[5] = w0 * bfhi(a0.z) + w1 * bfhi(a1.z) + w2 * bfhi(a2.z);
        v[6] = w0 * bflo(a0.w) + w1 * bflo(a1.w) + w2 * bflo(a2.w); v[7] = w0 * bfhi(a0.w) + w1 * bfhi(a1.w) + w2 * bfhi(a2.w);
        float ss = 0.f;
#pragma unroll
        for (int j = 0; j < 8; ++j) ss += v[j] * v[j];
        const float ra = 1.0f / sqrtf(wave_sum(ss) * (1.0f / 512.0f) + RMS_EPS);
        v4u o; o.x = pk2(v[0] * ra * ga0[0], v[1] * ra * ga0[1]); o.y = pk2(v[2] * ra * ga0[2], v[3] * ra * ga0[3]); o.z = pk2(v[4] * ra * ga1[0], v[5] * ra * ga1[1]); o.w = pk2(v[6] * ra * ga1[2], v[7] * ra * ga1[3]);
        *(v4u*)(mixed + (size_t)t * 1024 + lane * 8) = o;
        const v4u y = *(const v4u*)(gated + (size_t)t * 512 + lane * 8);
        v[0] = bflo(y.x); v[1] = bfhi(y.x); v[2] = bflo(y.y); v[3] = bfhi(y.y); v[4] = bflo(y.z); v[5] = bfhi(y.z); v[6] = bflo(y.w); v[7] = bfhi(y.w);
        ss = 0.f;
#pragma unroll
        for (int j = 0; j < 8; ++j) ss += v[j] * v[j];
        const float rs = 1.0f / sqrtf(wave_sum(ss) * (1.0f / 512.0f) + RMS_EPS);
        o.x = pk2(v[0] * rs * gs0[0], v[1] * rs * gs0[1]); o.y = pk2(v[2] * rs * gs0[2], v[3] * rs * gs0[3]); o.z = pk2(v[4] * rs * gs1[0], v[5] * rs * gs1[1]); o.w = pk2(v[6] * rs * gs1[2], v[7] * rs * gs1[3]);
        *(v4u*)(mixed + (size_t)t * 1024 + 512 + lane * 8) = o;
    }
}
__device__ void ln_phase(float* h, bf16* hb, const float* gam, const float* bet, int lane, int gw, int NGW) {
    f32x4 gv[4], bv[4];
#pragma unroll
    for (int j = 0; j < 4; ++j) { gv[j] = *(const f32x4*)(gam + 4 * lane + 256 * j); bv[j] = *(const f32x4*)(bet + 4 * lane + 256 * j); }
    for (int t = gw; t < T; t += NGW) {
        float* row = h + (size_t)t * D + 4 * lane; f32x4 v[4]; float s = 0.f;
#pragma unroll
        for (int j = 0; j < 4; ++j) { v[j] = *(const f32x4*)(row + 256 * j); s += (v[j][0] + v[j][1]) + (v[j][2] + v[j][3]); }
        const float mean = wave_sum(s) * (1.0f / D); float s2 = 0.f;
#pragma unroll
        for (int j = 0; j < 4; ++j) { v[j] = v[j] - mean; s2 += (v[j][0] * v[j][0] + v[j][1] * v[j][1]) + (v[j][2] * v[j][2] + v[j][3] * v[j][3]); }
        const float rstd = 1.0f / sqrtf(wave_sum(s2) * (1.0f / D) + LN_EPS);
        bf16* orow = hb + (size_t)t * D + 4 * lane;
#pragma unroll
        for (int j = 0; j < 4; ++j) { const f32x4 y = v[j] * rstd * gv[j] + bv[j]; *(f32x4*)(row + 256 * j) = y; v2u w; w.x = pk2(y[0], y[1]); w.y = pk2(y[2], y[3]); *(v2u*)(orow + 256 * j) = w; }
    }
}
__global__ void __launch_bounds__(512) hymba_fwd(Args A) {
    extern __shared__ __attribute__((aligned(16))) unsigned char lds_raw[];
    LAS unsigned char* lds = (LAS unsigned char*)lds_raw;
    cg::grid_group grid = cg::this_grid();
    const int G = gridDim.x, c = blockIdx.x, NGW = G * 8;
#define PHASE_IDS() int tid = threadIdx.x; asm volatile("" : "+v"(tid)); const int lane = tid & 63, wave = __builtin_amdgcn_readfirstlane(tid >> 6), gw = c * 8 + wave; (void)lane; (void)gw
    unsigned char* ws = A.ws;
    bf16* hb = (bf16*)(ws + WS_HB); bf16* qkv = (bf16*)(ws + WS_QKV); bf16* ubuf = (bf16*)(ws + WS_UB); bf16* ob = (bf16*)(ws + WS_OB); bf16* yg = (bf16*)(ws + WS_YG);
    bf16* hid = (bf16*)(ws + WS_HID); float* lse = (float*)(ws + WS_LSE); bf16* gated = (bf16*)(ws + WS_GATED); bf16* mixed = (bf16*)(ws + WS_MIXED);

#ifndef SKIP_P0
    { PHASE_IDS(); phase0(A, lds, tid, lane, wave, G, c); }
#endif
    grid.sync();

    for (int l = 0; l < NL; ++l) {
#ifndef SKIP_P1
        { pg8::Gemm g{hb, (const bf16*)(ws + WS_WIN) + (size_t)l * NIN * D, T, NIN, D}; pg8::StaticOrder S; S.init(T, NIN, G, c);
          pg8::EpiProj E{qkv, ubuf, (const unsigned*)(ws + WS_ROPE), QSCALE};
          pg8::gemm_phase<pg8::EpiProj, pg8::StaticOrder, true, true>(lds, g, S, E); }
#endif
        grid.sync();
#ifndef SKIP_P2
        { PHASE_IDS(); const int per = (NB * NH * 48 + G - 1) / G; const int a0 = c * per, a1 = min(a0 + per, NB * NH * 48);
#ifdef NAIVE_ATTN
          (void)a0; (void)a1; attn_naive(qkv, ob, lse, lane, gw, NGW);
#else
          for (int a = a0; a < a1; ++a) attn_item(lds, qkv, ob, lse, a / 48, a % 48, tid, lane, wave);
#endif
#ifdef NAIVE_SSM
          ssm_naive(A, l, ubuf, yg, lane, gw, NGW);
          for (int s = 0; s < 0; s += G) { const int b = s >> 5, g = s & 31; const int lg = l * NG + g;
#else
          for (int s = c; s < NB * NG; s += G) { const int b = s >> 5, g = s & 31; const int lg = l * NG + g;
#endif
              ssm_item(lds, ubuf, (const bf16*)(ws + WS_HT) + (size_t)lg * 128 * 256, (const bf16*)(ws + WS_W3) + (size_t)lg * 256 * 384, (const float*)(ws + WS_LAM) + (size_t)lg * 128, yg, b, g, tid, lane, wave); }
          __syncthreads(); }
#endif
        grid.sync();
#ifndef SKIP_P3
        { pg8::Gemm g{yg, (const bf16*)(ws + WS_WGLU) + (size_t)l * SW * SW, T, SW, SW}; pg8::StaticOrder S; S.init(T, SW, G, c);
          pg8::EpiGlu E{yg, gated, A.b_glu + l * SW};
          pg8::gemm_phase<pg8::EpiGlu, pg8::StaticOrder, true, true>(lds, g, S, E); }
#endif
        grid.sync();
#ifndef SKIP_P4
        { PHASE_IDS(); finalize_phase(A, l, lane, gw, NGW); }
#endif
        grid.sync();
#ifndef SKIP_P5
        { pg8::Gemm g{mixed, (const bf16*)(ws + WS_WOUT) + (size_t)l * D * D, T, D, D}; pg8::StaticOrder S; S.init(T, D, G, c);
          pg8::EpiRes E{l == 0 ? A.x : A.out, A.out, A.b_out + l * D, DN_ALPHA};
          pg8::gemm_phase<pg8::EpiRes, pg8::StaticOrder, true, true>(lds, g, S, E); }
#endif
        grid.sync();
#ifndef SKIP_P6
        { PHASE_IDS(); ln_phase(A.out, hb, A.ln1_g + l * D, A.ln1_b + l * D, lane, gw, NGW); }
#endif
        grid.sync();
#ifndef SKIP_P7
        { pg8::Gemm g{hb, (const bf16*)(ws + WS_WFF1) + (size_t)l * FF * D, T, FF, D}; pg8::StaticOrder S; S.init(T, FF, G, c);
          pg8::EpiFF1 E{hid, A.b_ff1 + l * FF};
          pg8::gemm_phase<pg8::EpiFF1, pg8::StaticOrder, true, true>(lds, g, S, E); }
#endif
        grid.sync();
#ifndef SKIP_P8
        { pg8::Gemm g{hid, (const bf16*)(ws + WS_WFF2) + (size_t)l * D * FF, T, D, FF}; pg8::StaticOrder S; S.init(T, D, G, c);
          pg8::EpiRes E{A.out, A.out, A.b_ff2 + l * D, DN_ALPHA};
          pg8::gemm_phase<pg8::EpiRes, pg8::StaticOrder, true, true>(lds, g, S, E); }
#endif
        grid.sync();
#ifndef SKIP_P9
        { PHASE_IDS(); ln_phase(A.out, hb, A.ln2_g + l * D, A.ln2_b + l * D, lane, gw, NGW); }
#endif
        if (l + 1 < NL) grid.sync();
    }
}

extern "C" void kernel_launch(void* const* d_in, const int* in_sizes, int n_in, void* d_out, int out_size, void* d_ws, size_t ws_size, hipStream_t stream) {
    static int grid = 0;
    if (grid == 0) {
        if (n_in != 25 || ws_size < WS_END) { fprintf(stderr, "kernel_launch: unexpected inputs (n_in %d, ws %zu, need %zu)\n", n_in, ws_size, (size_t)WS_END); grid = -1; return; }
        int dev = 0, cus = 0, per_cu = 0;
        hipGetDevice(&dev);
        hipDeviceGetAttribute(&cus, hipDeviceAttributeMultiprocessorCount, dev);
        if (hipFuncSetAttribute((const void*)hymba_fwd, hipFuncAttributeMaxDynamicSharedMemorySize, LDS_BYTES) != hipSuccess) { fprintf(stderr, "kernel_launch: hipFuncSetAttribute failed\n"); grid = -1; return; }
        if (hipOccupancyMaxActiveBlocksPerMultiprocessor(&per_cu, (const void*)hymba_fwd, 512, LDS_BYTES) != hipSuccess || per_cu < 1) { fprintf(stderr, "kernel_launch: occupancy query says %d\n", per_cu); per_cu = 1; (void)hipGetLastError(); }
        grid = cus * per_cu;
    }
    if (grid < 0) return;
    Args a{};
    a.x = (const float*)d_in[0]; a.pos = (const int*)d_in[1]; a.w_in = (const float*)d_in[2]; a.attn_gain = (const float*)d_in[3]; a.ssm_gain = (const float*)d_in[4];
    a.a_re = (const float*)d_in[5]; a.a_im = (const float*)d_in[6]; a.log_dt = (const float*)d_in[7]; a.b_re = (const float*)d_in[8]; a.b_im = (const float*)d_in[9];
    a.c_re = (const float*)d_in[10]; a.c_im = (const float*)d_in[11]; a.dsk = (const float*)d_in[12]; a.w_glu = (const float*)d_in[13]; a.b_glu = (const float*)d_in[14];
    a.w_out = (const float*)d_in[15]; a.b_out = (const float*)d_in[16]; a.ln1_g = (const float*)d_in[17]; a.ln1_b = (const float*)d_in[18]; a.w_ff1 = (const float*)d_in[19];
    a.b_ff1 = (const float*)d_in[20]; a.w_ff2 = (const float*)d_in[21]; a.b_ff2 = (const float*)d_in[22]; a.ln2_g = (const float*)d_in[23]; a.ln2_b = (const float*)d_in[24];
    a.out = (float*)d_out; a.ws = (unsigned char*)d_ws;
    void* args[] = {&a};
    hipError_t e = hipLaunchCooperativeKernel((const void*)hymba_fwd, dim3(grid), dim3(512), args, LDS_BYTES, stream);
    if (e != hipSuccess) fprintf(stderr, "kernel_launch: cooperative launch failed: %s (grid %d)\n", hipGetErrorString(e), grid);
}
```
